# Optimizing an MI355X kernel written in HIP

```python
import jax, jax.numpy as jnp
from jax import lax
import numpy as np

D_MODEL = 1024
BATCH = 32
SEQ = 256
DEPTH = 4
DEC_BATCH = 2
DEC_SEQ = 2048
PAST_LEN = 256

GRID_W = 64
HEAD_DIM = 64
N_HEADS = D_MODEL // HEAD_DIM
N_KV_HEADS = N_HEADS // 4
NA_KH = 8
NA_KW = 16
D_FF = ((8 * D_MODEL // 3 + 127) // 128) * 128
CONV_W = 3
Q_BLOCK = 128
ROPE_BASE = 10000.0
EPS = 1e-6
N_MIXERS = 2

kernel_name = 'hybrid_na_gqa_diffusion_step'


def rmsnorm(x, g):
    xf = x.astype(jnp.float32)
    y = xf * lax.rsqrt(jnp.mean(xf * xf, axis=-1, keepdims=True) + EPS)
    return (y * g.astype(jnp.float32)).astype(x.dtype)


def adaln(cond, w, b):
    m = jax.nn.silu(cond) @ w + b
    return jnp.split(m[..., None, :], 6, axis=-1)


def axial_rope(x):
    t = x.shape[1]
    pos = jnp.arange(t)
    rows = (pos // GRID_W).astype(jnp.float32)
    cols = (pos % GRID_W).astype(jnp.float32)
    half = HEAD_DIM // 2
    quarter = half // 2
    freqs = ROPE_BASE ** (-jnp.arange(quarter, dtype=jnp.float32) / quarter)

    def rot(xp, p):
        ang = p[:, None] * freqs[None, :]
        cos = jnp.cos(ang)[None, :, None, :].astype(x.dtype)
        sin = jnp.sin(ang)[None, :, None, :].astype(x.dtype)
        x1, x2 = xp[..., :quarter], xp[..., quarter:]
        return jnp.concatenate([x1 * cos - x2 * sin, x1 * sin + x2 * cos], axis=-1)

    return jnp.concatenate([rot(x[..., :half], rows), rot(x[..., half:], cols)], axis=-1)


def blocked_attention(q, k, v):
    b, t, h, dh = q.shape
    hkv = k.shape[2]
    g = h // hkv
    nblk = t // Q_BLOCK
    qb = q.reshape(b, nblk, Q_BLOCK, hkv, g, dh).transpose(1, 0, 2, 3, 4, 5)
    scale = dh ** -0.5

    def one(qi):
        s = jnp.einsum('bqkgd,bskd->bkgqs', qi, k).astype(jnp.float32) * scale
        p = jax.nn.softmax(s, axis=-1).astype(v.dtype)
        return jnp.einsum('bkgqs,bskd->bqkgd', p, v)

    o = lax.map(one, qb)
    return o.transpose(1, 0, 2, 3, 4, 5).reshape(b, t, h, dh)


def neighbourhood_attention(q, k, v, k_ctx, v_ctx, rpb):
    b, t, h, dh = q.shape
    rows = t // GRID_W
    kh = min(NA_KH, rows)
    kw = NA_KW
    r = jnp.arange(rows)
    col = jnp.arange(GRID_W)
    r_start = jnp.clip(r - kh // 2, 0, rows - kh)
    row_idx = r_start[:, None] + jnp.arange(kh)[None, :]
    c_start = jnp.clip(col - kw // 2, 0, GRID_W - kw)
    col_ok = (col[None, :] >= c_start[:, None]) & (col[None, :] < c_start[:, None] + kw)
    qg = q.reshape(b, rows, GRID_W, h, dh)
    kg = k.reshape(b, rows, GRID_W, h, dh)[:, row_idx]
    vg = v.reshape(b, rows, GRID_W, h, dh)[:, row_idx]
    scale = dh ** -0.5
    s_lat = jnp.einsum('brqhd,brkwhd->bhrqkw', qg, kg).astype(jnp.float32) * scale
    dr = row_idx - r[:, None] + (NA_KH - 1)
    dc = jnp.clip(col[None, :] - col[:, None] + (NA_KW - 1), 0, 2 * NA_KW - 2)
    bias = rpb[:, dr[:, None, :, None], dc[None, :, None, :]].astype(jnp.float32)
    s_lat = jnp.where(col_ok[None, None, None, :, None, :], s_lat + bias[None], -jnp.inf)
    s_ctx = jnp.einsum('brqhd,bchd->bhrqc', qg, k_ctx).astype(jnp.float32) * scale
    n_lat = kh * GRID_W
    s = jnp.concatenate([s_lat.reshape(b, h, rows, GRID_W, n_lat), s_ctx], axis=-1)
    p = jax.nn.softmax(s, axis=-1).astype(v.dtype)
    p_lat = p[..., :n_lat].reshape(b, h, rows, GRID_W, kh, GRID_W)
    p_ctx = p[..., n_lat:]
    o = jnp.einsum('bhrqkw,brkwhd->brqhd', p_lat, vg) + jnp.einsum('bhrqc,bchd->brqhd', p_ctx, v_ctx)
    return o.reshape(b, t, h, dh)


def na_qkv(h, w_qkv):
    b, t, _ = h.shape
    q, k, v = jnp.split(h @ w_qkv, 3, axis=-1)
    return (q.reshape(b, t, N_HEADS, HEAD_DIM), k.reshape(b, t, N_HEADS, HEAD_DIM),
            v.reshape(b, t, N_HEADS, HEAD_DIM))


def gqa_qkv(h, w_qkv, q_norm, k_norm):
    b, t, _ = h.shape
    qk = N_HEADS * HEAD_DIM
    kv = N_KV_HEADS * HEAD_DIM
    q, k, v = jnp.split(h @ w_qkv, [qk, qk + kv], axis=-1)
    q = rmsnorm(q.reshape(b, t, N_HEADS, HEAD_DIM), q_norm)
    k = rmsnorm(k.reshape(b, t, N_KV_HEADS, HEAD_DIM), k_norm)
    return q, k, v.reshape(b, t, N_KV_HEADS, HEAD_DIM)


def conv_ffn(h, w_up, conv_w, conv_b, w_down):
    u = h @ w_up
    up = jnp.pad(u, ((0, 0), (1, 1), (0, 0)))
    u = up[:, :-2] * conv_w[0] + up[:, 1:-1] * conv_w[1] + up[:, 2:] * conv_w[2] + conv_b
    a, gt = jnp.split(u, 2, axis=-1)
    return (jax.nn.silu(a) * gt) @ w_down


def setup_inputs(seed: int = 0) -> dict:
    key = jax.random.key(seed)
    ks = jax.random.split(key, 24)
    n_a = (DEPTH + N_MIXERS - 1) // N_MIXERS
    n_b = DEPTH // N_MIXERS
    f32 = jnp.float32
    D = D_MODEL

    def nrm(k, shape, scale):
        return jax.random.normal(k, shape, f32) * scale

    def gain(k, shape):
        return 1.0 + 0.1 * jax.random.normal(k, shape, f32)

    return {
        'x_prompt': nrm(ks[0], (BATCH, SEQ, D), 1.0),
        'x_sample': nrm(ks[1], (DEC_BATCH, DEC_SEQ, D), 1.0),
        'cache_na_k': nrm(ks[2], (DEC_BATCH, n_a, PAST_LEN, N_HEADS, HEAD_DIM), 1.0),
        'cache_na_v': nrm(ks[3], (DEC_BATCH, n_a, PAST_LEN, N_HEADS, HEAD_DIM), 1.0),
        'cache_gqa_k': nrm(ks[4], (DEC_BATCH, n_b, PAST_LEN, N_KV_HEADS, HEAD_DIM), 1.0),
        'cache_gqa_v': nrm(ks[5], (DEC_BATCH, n_b, PAST_LEN, N_KV_HEADS, HEAD_DIM), 1.0),
        'c': nrm(ks[6], (DEC_BATCH, D), 1.0),
        'c_ctx': nrm(ks[7], (D,), 1.0),
        'ada_w': nrm(ks[8], (DEPTH, D, 6 * D), 0.5 * D ** -0.5),
        'ada_b': nrm(ks[9], (DEPTH, 6 * D), 0.02),
        'norm_mix_pre': gain(ks[10], (DEPTH, D)),
        'norm_mix_post': gain(ks[11], (DEPTH, D)),
        'norm_ffn_pre': gain(ks[12], (DEPTH, D)),
        'norm_ffn_post': gain(ks[13], (DEPTH, D)),
        'na_w_qkv': nrm(ks[14], (n_a, D, 3 * N_HEADS * HEAD_DIM), D ** -0.5),
        'na_w_o': nrm(ks[15], (n_a, N_HEADS * HEAD_DIM, D), (N_HEADS * HEAD_DIM) ** -0.5),
        'na_rpb': nrm(ks[16], (n_a, N_HEADS, 2 * NA_KH - 1, 2 * NA_KW - 1), 0.5),
        'gqa_w_qkv': nrm(ks[17], (n_b, D, (N_HEADS + 2 * N_KV_HEADS) * HEAD_DIM), D ** -0.5),
        'gqa_w_o': nrm(ks[18], (n_b, N_HEADS * HEAD_DIM, D), (N_HEADS * HEAD_DIM) ** -0.5),
        'gqa_q_norm': gain(ks[19], (n_b, HEAD_DIM)),
        'gqa_k_norm': gain(ks[20], (n_b, HEAD_DIM)),
        'ffn_w_up': nrm(ks[21], (DEPTH, D, 2 * D_FF), D ** -0.5),
        'ffn_conv_w': nrm(ks[22], (DEPTH, CONV_W, 2 * D_FF), CONV_W ** -0.5),
        'ffn_conv_b': nrm(jax.random.fold_in(ks[22], 1), (DEPTH, 2 * D_FF), 0.02),
        'ffn_w_down': nrm(ks[23], (DEPTH, D_FF, D), D_FF ** -0.5),
    }


def reference(x_prompt, x_sample, cache_na_k, cache_na_v, cache_gqa_k, cache_gqa_v, c, c_ctx,
              ada_w, ada_b, norm_mix_pre, norm_mix_post, norm_ffn_pre, norm_ffn_post,
              na_w_qkv, na_w_o, na_rpb, gqa_w_qkv, gqa_w_o, gqa_q_norm, gqa_k_norm,
              ffn_w_up, ffn_conv_w, ffn_conv_b, ffn_w_down):
    xp, xs = x_prompt, x_sample
    bp, tp, _ = xp.shape
    bs, ts, _ = xs.shape
    new_na_k, new_na_v, new_gqa_k, new_gqa_v = [], [], [], []
    for l in range(DEPTH):
        i = l // N_MIXERS
        sh_ap, sc_ap, g_ap, sh_fp, sc_fp, g_fp = adaln(c_ctx, ada_w[l], ada_b[l])
        sh_as, sc_as, g_as, sh_fs, sc_fs, g_fs = adaln(c, ada_w[l], ada_b[l])
        hp = rmsnorm(xp, norm_mix_pre[l]) * (1.0 + sc_ap) + sh_ap
        hs = rmsnorm(xs, norm_mix_pre[l]) * (1.0 + sc_as) + sh_as
        if l % N_MIXERS == 0:
            qp, kp, vp = na_qkv(hp, na_w_qkv[i])
            op = blocked_attention(qp, kp, vp)
            new_na_k.append(kp)
            new_na_v.append(vp)
            qs, ks_, vs = na_qkv(hs, na_w_qkv[i])
            os_ = neighbourhood_attention(qs, ks_, vs, cache_na_k[:, i], cache_na_v[:, i], na_rpb[i])
            w_o = na_w_o[i]
        else:
            qp, kp, vp = gqa_qkv(hp, gqa_w_qkv[i], gqa_q_norm[i], gqa_k_norm[i])
            op = blocked_attention(qp, kp, vp)
            new_gqa_k.append(kp)
            new_gqa_v.append(vp)
            qs, ks_, vs = gqa_qkv(hs, gqa_w_qkv[i], gqa_q_norm[i], gqa_k_norm[i])
            qs = axial_rope(qs)
            ks_ = axial_rope(ks_)
            k_all = jnp.concatenate([ks_, cache_gqa_k[:, i]], axis=1)
            v_all = jnp.concatenate([vs, cache_gqa_v[:, i]], axis=1)
            os_ = blocked_attention(qs, k_all, v_all)
            w_o = gqa_w_o[i]
        xp = xp + g_ap * rmsnorm(op.reshape(bp, tp, -1) @ w_o, norm_mix_post[l])
        xs = xs + g_as * rmsnorm(os_.reshape(bs, ts, -1) @ w_o, norm_mix_post[l])
        hp = rmsnorm(xp, norm_ffn_pre[l]) * (1.0 + sc_fp) + sh_fp
        hs = rmsnorm(xs, norm_ffn_pre[l]) * (1.0 + sc_fs) + sh_fs
        fp = conv_ffn(hp, ffn_w_up[l], ffn_conv_w[l], ffn_conv_b[l], ffn_w_down[l])
        fs = conv_ffn(hs, ffn_w_up[l], ffn_conv_w[l], ffn_conv_b[l], ffn_w_down[l])
        xp = xp + g_fp * rmsnorm(fp, norm_ffn_post[l])
        xs = xs + g_fs * rmsnorm(fs, norm_ffn_post[l])
    na_k_out = jnp.stack(new_na_k, axis=1)
    na_v_out = jnp.stack(new_na_v, axis=1)
    gqa_k_out = jnp.stack(new_gqa_k, axis=1)
    gqa_v_out = jnp.stack(new_gqa_v, axis=1)
    return (xp, xs, na_k_out, na_v_out, gqa_k_out, gqa_v_out)
```

```cpp
#include <hip/hip_runtime.h>
#include <cstdio>
#include <cstdint>

#define LAS __attribute__((address_space(3)))
#define GAS __attribute__((address_space(1)))
typedef unsigned short bf16_t;
typedef short bf16x8 __attribute__((ext_vector_type(8)));
typedef short s16x4 __attribute__((ext_vector_type(4)));
typedef float f32x4 __attribute__((ext_vector_type(4)));
typedef float f32x2 __attribute__((ext_vector_type(2)));
typedef float f32x16 __attribute__((ext_vector_type(16)));
typedef unsigned u32x4 __attribute__((ext_vector_type(4)));
typedef unsigned u32x2 __attribute__((ext_vector_type(2)));
typedef __bf16 bf16x2_t __attribute__((ext_vector_type(2)));

__device__ __forceinline__ unsigned pk2(float lo, float hi) { f32x2 v = {lo, hi}; bf16x2_t b = __builtin_convertvector(v, bf16x2_t); return __builtin_bit_cast(unsigned, b); }
__device__ __forceinline__ float bf2f(unsigned short h) { return __builtin_bit_cast(float, (unsigned)h << 16); }

constexpr int D = 1024, NP = 8192, NS = 4096, NTOK = NP + NS, DFF = 2816, NUP = 2 * DFF, HD = 64;
constexpr float EPS = 1e-6f;
constexpr float QS = 0.125f * 1.4426950408889634f;
constexpr float LOG2E = 1.4426950408889634f;

namespace pg8 {
constexpr int BM = 256, BK = 64, HALF = 128, HTB = HALF * BK * 2, STAGE_BYTES = 8 * HTB, NXCD = 8, WGM = 8;
__host__ __device__ __forceinline__ int lds_byte(int r, int c) { const int st = (r >> 4) * 2 + (c >> 5), rr = r & 15, cc = c & 31, ob = rr * 64 + cc * 2; return st * 1024 + (ob ^ (((ob >> 9) & 1) << 5)); }
__host__ __device__ __forceinline__ void stage_rc(int b, int& R, int& C) { const int st = b / 1024, sb = b % 1024, swz = sb ^ (((sb >> 9) & 1) << 5); R = (st >> 1) * 16 + swz / 64; C = (st & 1) * 32 + (swz % 64) / 2; }
__host__ __device__ __forceinline__ int perm32(int rho) { const int n = rho >> 4, i = rho & 15; return 8 * (i >> 2) + 4 * n + (i & 3); }

struct Unit { int pm, pn; };
struct Gemm { const bf16_t* A; const bf16_t* Bt; int M, N, K; };

struct StaticOrder {
    int nM, nN, nwg, G, c;
    __host__ __device__ void init(int M, int N, int G_, int c_) { nM = M / BM; nN = N / BM; nwg = nM * nN; G = G_; c = c_; }
    __host__ __device__ bool next(int i, Unit& u) const {
        const long L = (long)i * G + c; if (L >= nwg) return false;
        int wgid = (int)L; { const int q = nwg / NXCD, r = nwg % NXCD, xcd = wgid % NXCD, off = wgid / NXCD; wgid = (xcd < r ? xcd * (q + 1) : r * (q + 1) + (xcd - r) * q) + off; }
        const int nig = WGM * nN, gid = wgid / nig, fm = gid * WGM, gsz = (nM - fm) < WGM ? (nM - fm) : WGM;
        u.pm = fm + ((wgid % nig) % gsz); u.pn = (wgid % nig) / gsz; return true;
    }
    __device__ __forceinline__ void a_ready(const Unit&) const {}
    __device__ __forceinline__ void done(const Unit&) const {}
};


template <class Epi, class Sched, bool ALIGN_EPI = false, bool SP2 = false>
__device__ __forceinline__ void gemm_phase(LAS unsigned char* lds, const Gemm g, const Sched& S, const Epi& E) {
    int tid = threadIdx.x; asm volatile("" : "+v"(tid));
    const int wid = __builtin_amdgcn_readfirstlane(tid >> 6), lane = tid & 63, wr = wid >> 2, wc = wid & 3, fr = lane & 15, fq = lane >> 4;
    const int K = g.K, nt = K / BK;
    unsigned voffA[2], voffB[2];
#pragma unroll
    for (int i = 0; i < 2; ++i) { int R, C; stage_rc(tid * 16 + i * 8192, R, C); const int Rb = Epi::PERM ? ((R & ~31) + perm32(R & 31)) : R;
        voffA[i] = (unsigned)(R * K + C) * 2u; voffB[i] = (unsigned)(Rb * K + C) * 2u; }
    const size_t kstep = (size_t)(BK * 2);
    const size_t hstep = (size_t)HALF * K * 2;
    const size_t tstep = 2 * hstep;
    const unsigned ldsw = (unsigned)wid * 1024u;
    const int aoff = lds_byte(wr * 64 + fr, fq * 8), boff = lds_byte(wc * 32 + fr, fq * 8);
#define PG8_SA(b, h) (((b) * 2 + (h)) * HTB)
#define PG8_SB(b, h) ((4 + (b) * 2 + (h)) * HTB)
#define PG8_STAGE(bufoff, gbase, voff) do { _Pragma("unroll") for (int _i = 0; _i < 2; ++_i) \
        __builtin_amdgcn_global_load_lds((const unsigned*)((const char*)(gbase) + (voff)[_i]), (LAS unsigned*)(lds + (bufoff) + ldsw + _i * 8192), 16, 0, 0); } while (0)
#define PG8_LDA(dst, b, h) do { _Pragma("unroll") for (int m = 0; m < 4; ++m) _Pragma("unroll") for (int k = 0; k < 2; ++k) dst[m][k] = *(const LAS bf16x8*)(lds + PG8_SA(b, h) + aoff + m * 2048 + k * 1024); } while (0)
#define PG8_LDB(dst, b, h) do { _Pragma("unroll") for (int n = 0; n < 2; ++n) _Pragma("unroll") for (int k = 0; k < 2; ++k) dst[n][k] = *(const LAS bf16x8*)(lds + PG8_SB(b, h) + boff + n * 2048 + k * 1024); } while (0)
#define PG8_MMA(ai, bj, At, Bt) do { __builtin_amdgcn_s_setprio(1); _Pragma("unroll") for (int m = 0; m < 4; ++m) _Pragma("unroll") for (int n = 0; n < 2; ++n) _Pragma("unroll") for (int k = 0; k < 2; ++k) \
        acc[ai][bj][m][n] = __builtin_amdgcn_mfma_f32_16x16x32_bf16(Bt[n][k], At[m][k], acc[ai][bj][m][n], 0, 0, 0); __builtin_amdgcn_s_setprio(0); } while (0)
#define PG8_WAIT_V(n) asm volatile("s_waitcnt vmcnt(" #n ")" ::: "memory")
#define PG8_WAIT_L(n) asm volatile("s_waitcnt lgkmcnt(" #n ")" ::: "memory")
#define PG8_BAR __builtin_amdgcn_s_barrier()
#define PG8_SCHED __builtin_amdgcn_sched_barrier(0)
    Unit cur, nxt; int ui = 0;
    if (!S.next(0, cur)) return;
    f32x4 acc[2][2][4][2];
#pragma unroll
    for (int a = 0; a < 2; ++a)
#pragma unroll
        for (int b = 0; b < 2; ++b)
#pragma unroll
            for (int m = 0; m < 4; ++m)
#pragma unroll
                for (int n = 0; n < 2; ++n) acc[a][b][m][n] = (f32x4){0.f, 0.f, 0.f, 0.f};
    bf16x8 At[4][2], B0[2][2], B1[2][2];
    const char* cA = (const char*)g.A + (size_t)cur.pm * tstep; const char* cB = (const char*)g.Bt + (size_t)cur.pn * tstep;
    S.a_ready(cur);
    if constexpr (SP2) {
        PG8_STAGE(PG8_SB(0, 0), cB, voffB); PG8_STAGE(PG8_SB(0, 1), cB + hstep, voffB); PG8_STAGE(PG8_SA(0, 0), cA, voffA); PG8_STAGE(PG8_SA(0, 1), cA + hstep, voffA);
        if (wr == 1) PG8_BAR;
        PG8_WAIT_V(2); PG8_BAR;
        PG8_STAGE(PG8_SB(1, 0), cB + kstep, voffB); PG8_STAGE(PG8_SA(1, 0), cA + kstep, voffA); PG8_STAGE(PG8_SB(1, 1), cB + hstep + kstep, voffB);
        PG8_WAIT_V(6); PG8_BAR;
    } else {
        PG8_STAGE(PG8_SB(0, 0), cB, voffB); PG8_STAGE(PG8_SA(0, 0), cA, voffA); PG8_STAGE(PG8_SB(0, 1), cB + hstep, voffB); PG8_STAGE(PG8_SA(0, 1), cA + hstep, voffA);
        if (wr == 1) PG8_BAR;
        PG8_WAIT_V(4); PG8_BAR;
        PG8_STAGE(PG8_SB(1, 0), cB + kstep, voffB); PG8_STAGE(PG8_SA(1, 0), cA + kstep, voffA); PG8_STAGE(PG8_SB(1, 1), cB + hstep + kstep, voffB);
        PG8_WAIT_V(6); PG8_BAR;
    }
    for (;;) {
        const bool has_next = S.next(ui + 1, nxt);
        const char* nA = has_next ? (const char*)g.A + (size_t)nxt.pm * tstep : cA; const char* nB = has_next ? (const char*)g.Bt + (size_t)nxt.pn * tstep : cB;
        for (int t = 0; t < nt; t += 2) {
            const bool last = (t == nt - 2);
            const char* a1 = cA + (size_t)(t + 1) * kstep;
            const char* a2 = last ? nA : cA + (size_t)(t + 2) * kstep; const char* b2 = last ? nB : cB + (size_t)(t + 2) * kstep;
            const char* a3 = a2 + kstep; const char* b3 = b2 + kstep;
            if (last && has_next) S.a_ready(nxt);
            if constexpr (SP2) {
            PG8_LDB(B0, 0, 0); PG8_LDB(B1, 0, 1); PG8_SCHED; PG8_LDA(At, 0, 0); PG8_STAGE(PG8_SA(1, 1), a1 + hstep, voffA);
            PG8_WAIT_V(8); PG8_WAIT_L(0); PG8_BAR; PG8_MMA(0, 0, At, B0); PG8_MMA(0, 1, At, B1); PG8_BAR; PG8_SCHED;
            PG8_LDA(At, 0, 1); PG8_STAGE(PG8_SB(0, 0), b2, voffB); PG8_STAGE(PG8_SB(0, 1), b2 + hstep, voffB); PG8_STAGE(PG8_SA(0, 0), a2, voffA);
            PG8_WAIT_V(8); PG8_WAIT_L(0); PG8_BAR; PG8_MMA(1, 0, At, B0); PG8_MMA(1, 1, At, B1); PG8_BAR; PG8_SCHED;
            PG8_LDB(B0, 1, 0); PG8_LDB(B1, 1, 1); PG8_SCHED; PG8_LDA(At, 1, 0); PG8_STAGE(PG8_SA(0, 1), a2 + hstep, voffA);
            PG8_WAIT_V(8); PG8_WAIT_L(0); PG8_BAR; PG8_MMA(0, 0, At, B0); PG8_MMA(0, 1, At, B1); PG8_BAR; PG8_SCHED;
            PG8_LDA(At, 1, 1); PG8_STAGE(PG8_SB(1, 0), b3, voffB); PG8_STAGE(PG8_SB(1, 1), b3 + hstep, voffB); PG8_STAGE(PG8_SA(1, 0), a3, voffA);
            PG8_WAIT_V(8); PG8_WAIT_L(0); PG8_BAR; PG8_MMA(1, 0, At, B0); PG8_MMA(1, 1, At, B1); PG8_BAR; PG8_SCHED;
            } else {
            PG8_LDB(B0, 0, 0); PG8_SCHED; PG8_LDA(At, 0, 0); PG8_STAGE(PG8_SA(1, 1), a1 + hstep, voffA);
            PG8_WAIT_L(8); PG8_BAR; PG8_WAIT_L(0); PG8_MMA(0, 0, At, B0); PG8_BAR; PG8_SCHED;
            PG8_LDB(B1, 0, 1); PG8_STAGE(PG8_SB(0, 0), b2, voffB);
            PG8_BAR; PG8_WAIT_L(0); PG8_MMA(0, 1, At, B1); PG8_BAR;
            PG8_LDA(At, 0, 1); PG8_STAGE(PG8_SA(0, 0), a2, voffA);
            PG8_BAR; PG8_WAIT_L(0); PG8_MMA(1, 0, At, B0); PG8_BAR; PG8_SCHED;
            PG8_STAGE(PG8_SB(0, 1), b2 + hstep, voffB);
            PG8_WAIT_V(6); PG8_BAR; PG8_MMA(1, 1, At, B1); PG8_BAR;
            PG8_LDB(B0, 1, 0); PG8_SCHED; PG8_LDA(At, 1, 0); PG8_STAGE(PG8_SA(0, 1), a2 + hstep, voffA);
            PG8_WAIT_L(8); PG8_BAR; PG8_WAIT_L(0); PG8_MMA(0, 0, At, B0); PG8_BAR; PG8_SCHED;
            PG8_LDB(B1, 1, 1); PG8_STAGE(PG8_SB(1, 0), b3, voffB);
            PG8_BAR; PG8_WAIT_L(0); PG8_MMA(0, 1, At, B1); PG8_BAR;
            PG8_LDA(At, 1, 1); PG8_STAGE(PG8_SA(1, 0), a3, voffA);
            PG8_BAR; PG8_WAIT_L(0); PG8_MMA(1, 0, At, B0); PG8_BAR; PG8_SCHED;
            PG8_STAGE(PG8_SB(1, 1), b3 + hstep, voffB);
            PG8_WAIT_V(6); PG8_BAR; PG8_MMA(1, 1, At, B1); PG8_BAR;
            }
        }
        if constexpr (ALIGN_EPI) { if (wr == 0) PG8_BAR; }
        E(acc, cur, wr, wc, fr, fq); S.done(cur);
        if (!has_next) break;
#pragma unroll
        for (int a = 0; a < 2; ++a)
#pragma unroll
            for (int b = 0; b < 2; ++b)
#pragma unroll
                for (int m = 0; m < 4; ++m)
#pragma unroll
                    for (int n = 0; n < 2; ++n) acc[a][b][m][n] = (f32x4){0.f, 0.f, 0.f, 0.f};
        cur = nxt; cA = nA; cB = nB; ++ui;
        if constexpr (ALIGN_EPI) { if (wr == 1) PG8_BAR; }
    }
    PG8_WAIT_V(0);
    if constexpr (!ALIGN_EPI) { if (wr == 0) PG8_BAR; }
    PG8_BAR;
#undef PG8_SA
#undef PG8_SB
#undef PG8_STAGE
#undef PG8_LDA
#undef PG8_LDB
#undef PG8_MMA
#undef PG8_WAIT_V
#undef PG8_WAIT_L
#undef PG8_BAR
#undef PG8_SCHED
}
}

struct EpiF32 {
    static constexpr bool PERM = false;
    float* out;
    __device__ __forceinline__ void operator()(const f32x4 (&acc)[2][2][4][2], const pg8::Unit& u, int wr, int wc, int fr, int fq) const {
        asm volatile("" : "+v"(fr), "+v"(fq));
#pragma unroll
        for (int ai = 0; ai < 2; ++ai)
#pragma unroll
            for (int m = 0; m < 4; ++m) {
                const int r = u.pm * 256 + ai * 128 + wr * 64 + m * 16 + fr;
                float* rowp = out + (size_t)r * D + u.pn * 256 + wc * 32 + 4 * fq;
#pragma unroll
                for (int bj = 0; bj < 2; ++bj)
#pragma unroll
                    for (int n = 0; n < 2; ++n) *(f32x4*)(rowp + bj * 128 + n * 16) = acc[ai][bj][m][n];
            }
    }
};
struct EpiUp {
    static constexpr bool PERM = false;
    bf16_t* U;
    __device__ __forceinline__ void operator()(const f32x4 (&acc)[2][2][4][2], const pg8::Unit& u, int wr, int wc, int fr, int fq) const {
        asm volatile("" : "+v"(fr), "+v"(fq));
#pragma unroll
        for (int ai = 0; ai < 2; ++ai)
#pragma unroll
            for (int m = 0; m < 4; ++m) {
                const int r = u.pm * 256 + ai * 128 + wr * 64 + m * 16 + fr;
                bf16_t* rowp = U + (size_t)r * NUP + u.pn * 128 + wc * 32 + 4 * fq;
#pragma unroll
                for (int bj = 0; bj < 2; ++bj)
#pragma unroll
                    for (int n = 0; n < 2; ++n) { const f32x4 v = acc[ai][bj][m][n]; u32x2 w; w.x = pk2(v[0], v[1]); w.y = pk2(v[2], v[3]); *(u32x2*)(rowp + bj * DFF + n * 16) = w; }
            }
    }
};
struct EpiQKV {
    static constexpr bool PERM = false;
    bf16_t *Q, *K, *V; int kvpitch; float *outk, *outv; int gqa; const float *qn, *kn; const float *ropec, *ropes;
    __device__ __forceinline__ void operator()(const f32x4 (&acc)[2][2][4][2], const pg8::Unit& u, int wr, int wc, int fr, int fq) const {
        asm volatile("" : "+v"(fr), "+v"(fq));
        int kind, colbase;
        if (!gqa) { kind = u.pn >> 2; colbase = 256 * (u.pn & 3); } else { kind = u.pn < 4 ? 0 : u.pn - 3; colbase = u.pn < 4 ? 256 * u.pn : 0; }
        const bool prompt = u.pm < 32;
        const int col0 = colbase + 64 * wc + 4 * fq;
        f32x4 gn[2][2];
        if (gqa && kind != 2) { const float* gp = (kind == 0 ? qn : kn) + 4 * fq;
#pragma unroll
            for (int bj = 0; bj < 2; ++bj)
#pragma unroll
                for (int n = 0; n < 2; ++n) gn[bj][n] = *(const f32x4*)(gp + 32 * bj + 16 * n); }
#pragma unroll
        for (int ai = 0; ai < 2; ++ai)
#pragma unroll
            for (int m = 0; m < 4; ++m) {
                const int r = u.pm * 256 + ai * 128 + wr * 64 + m * 16 + fr;
                f32x4 v[2][2];
#pragma unroll
                for (int bj = 0; bj < 2; ++bj)
#pragma unroll
                    for (int n = 0; n < 2; ++n) v[bj][n] = acc[ai][bj][m][n];
                if (gqa && kind != 2) {
                    float ss = 0.f;
#pragma unroll
                    for (int bj = 0; bj < 2; ++bj)
#pragma unroll
                        for (int n = 0; n < 2; ++n) { const f32x4 x = v[bj][n]; ss += (x[0] * x[0] + x[1] * x[1]) + (x[2] * x[2] + x[3] * x[3]); }
                    ss += __shfl_xor(ss, 16); ss += __shfl_xor(ss, 32);
                    const float rinv = 1.0f / sqrtf(ss * (1.0f / 64.0f) + EPS);
#pragma unroll
                    for (int bj = 0; bj < 2; ++bj)
#pragma unroll
                        for (int n = 0; n < 2; ++n) v[bj][n] = v[bj][n] * rinv * gn[bj][n];
                    if (kind == 1 && prompt) {
                        float* op = outk + ((size_t)(r >> 8) * 512 + (r & 255)) * kvpitch + col0;
#pragma unroll
                        for (int bj = 0; bj < 2; ++bj)
#pragma unroll
                            for (int n = 0; n < 2; ++n) *(f32x4*)(op + 32 * bj + 16 * n) = v[bj][n];
                    }
                    if (!prompt) {
                        const int t = (r - NP) & 2047; const int p0 = t >> 6, p1 = t & 63;
#pragma unroll
                        for (int bj = 0; bj < 2; ++bj) { const int p = bj ? p1 : p0;
                            const f32x4 c4 = *(const f32x4*)(ropec + p * 16 + 4 * fq), s4 = *(const f32x4*)(ropes + p * 16 + 4 * fq);
                            const f32x4 x1 = v[bj][0], x2 = v[bj][1];
                            v[bj][0] = x1 * c4 - x2 * s4; v[bj][1] = x1 * s4 + x2 * c4; }
                    }
                }
                if (kind == 0) {
                    bf16_t* qp = Q + (size_t)r * D + col0;
#pragma unroll
                    for (int bj = 0; bj < 2; ++bj)
#pragma unroll
                        for (int n = 0; n < 2; ++n) { const f32x4 x = v[bj][n] * QS; u32x2 w; w.x = pk2(x[0], x[1]); w.y = pk2(x[2], x[3]); *(u32x2*)(qp + 32 * bj + 16 * n) = w; }
                } else {
                    bf16_t* kp = (kind == 1 ? K : V) + (size_t)r * kvpitch + col0;
#pragma unroll
                    for (int bj = 0; bj < 2; ++bj)
#pragma unroll
                        for (int n = 0; n < 2; ++n) { const f32x4 x = v[bj][n]; u32x2 w; w.x = pk2(x[0], x[1]); w.y = pk2(x[2], x[3]); *(u32x2*)(kp + 32 * bj + 16 * n) = w; }
                    if (prompt && !(gqa && kind == 1)) {
                        float* op = (kind == 1 ? outk : outv) + ((size_t)(r >> 8) * 512 + (r & 255)) * kvpitch + col0;
#pragma unroll
                        for (int bj = 0; bj < 2; ++bj)
#pragma unroll
                            for (int n = 0; n < 2; ++n) *(f32x4*)(op + 32 * bj + 16 * n) = v[bj][n];
                    }
                }
            }
    }
};

#define XB_TMO      128
#define XB_XCNT(j)  (256  + 64 * (j))
#define XB_XSUB(j)  (1280 + 64 * (j))
#define XB_XGEN(j)  (2304 + 64 * (j))
#define XB_TOP      3328
#define XB_TOPGEN   3392
#define XCD_BAR_WORDS 3456
#define XB_SPIN_CAP (1u << 18)
__device__ __forceinline__ unsigned xb_ld(unsigned* p)              { return __hip_atomic_load(p, __ATOMIC_RELAXED, __HIP_MEMORY_SCOPE_AGENT); }
__device__ __forceinline__ unsigned xb_add(unsigned* p, unsigned v) { return __hip_atomic_fetch_add(p, v, __ATOMIC_RELAXED, __HIP_MEMORY_SCOPE_AGENT); }
__device__ __forceinline__ unsigned xb_xcc_id() { return (unsigned)__builtin_amdgcn_s_getreg((3 << 11) | 20) & 0xFu; }
#define XB_SPIN(cond, bar) do { unsigned _sp = 0; while (cond) { __builtin_amdgcn_s_sleep(1); \
    if ((++_sp & 255u) == 0u) { if (xb_ld(&(bar)[XB_TMO])) break; if (_sp > XB_SPIN_CAP) { atomicAdd(&(bar)[XB_TMO], 1u); break; } } } } while (0)
struct XcdBarrier { unsigned* bar; unsigned x; volatile LAS unsigned* st; };
__device__ __forceinline__ XcdBarrier xcd_barrier_post(unsigned* bar, volatile LAS unsigned* st) {
    XcdBarrier b; b.bar = bar; b.x = xb_xcc_id(); b.st = st;
    if (threadIdx.x == 0) (void)xb_add(&bar[XB_XCNT(b.x)], 1u);
    return b;
}
__device__ __forceinline__ void xcd_barrier_complete(unsigned* bar, unsigned x, unsigned& nloc, unsigned& nx) {
    const unsigned G = gridDim.x * gridDim.y * gridDim.z;
    unsigned sum, cnt, mine, sp = 0u;
    for (;;) {
        sum = 0u; cnt = 0u; mine = 0u;
#pragma unroll
        for (unsigned j = 0; j < 16; ++j) { const unsigned c = xb_ld(&bar[XB_XCNT(j)]); sum += c; cnt += (c > 0u) ? 1u : 0u; mine = (j == x) ? c : mine; }
        if (sum == G) break;
        __builtin_amdgcn_s_sleep(1);
        if ((++sp & 255u) == 0u) { if (xb_ld(&bar[XB_TMO])) break; if (sp > XB_SPIN_CAP) { atomicAdd(&bar[XB_TMO], 1u); break; } }
    }
    nloc = mine > 0u ? mine : 1u; nx = cnt > 0u ? cnt : 1u;
}
__device__ __forceinline__ void xcd_barrier(const XcdBarrier& b) {
    asm volatile("s_waitcnt vmcnt(0)" ::: "memory");
    __syncthreads();
    if (threadIdx.x == 0) {
        unsigned* bar = b.bar;
        __builtin_amdgcn_s_waitcnt(0);
        unsigned nloc = b.st[0], nx = b.st[1];
        if (nloc == 0u) { xcd_barrier_complete(bar, b.x, nloc, nx); b.st[0] = nloc; b.st[1] = nx; }
        const unsigned old = xb_add(&bar[XB_XSUB(b.x)], 1u);
        const unsigned gen = old / nloc;
        if (old + 1u == (gen + 1u) * nloc) {
            __builtin_amdgcn_fence(__ATOMIC_RELEASE, "agent");
            asm volatile("s_waitcnt vmcnt(0)" ::: "memory");
            const unsigned og = xb_add(&bar[XB_TOP], 1u);
            const unsigned tg = og / nx;
            if (og + 1u == (tg + 1u) * nx) xb_add(&bar[XB_TOPGEN], 1u);
            else XB_SPIN(xb_ld(&bar[XB_TOPGEN]) == tg, bar);
            __builtin_amdgcn_fence(__ATOMIC_ACQUIRE, "agent");
            xb_add(&bar[XB_XGEN(b.x)], 1u);
            asm volatile("s_waitcnt vmcnt(0)" ::: "memory");
        } else {
            XB_SPIN(xb_ld(&bar[XB_XGEN(b.x)]) == gen, bar);
            __builtin_amdgcn_fence(__ATOMIC_ACQUIRE, "agent");
            asm volatile("s_waitcnt vmcnt(0)" ::: "memory");
        }
    }
    __syncthreads();
}

constexpr size_t MiB = 1u << 20;
constexpr size_t WS_CTL = 0, CTL_ZERO_BYTES = 64 * 1024;
constexpr size_t WS_MOD = 1 * MiB;
constexpr size_t WS_ROPE = WS_MOD + 512 * 1024;
constexpr size_t WS_CACHE = 2 * MiB;
constexpr size_t WS_CNK = WS_CACHE, WS_CNV = WS_CACHE + 2 * MiB, WS_CGK = WS_CACHE + 4 * MiB, WS_CGV = WS_CACHE + 4 * MiB + 512 * 1024;
constexpr size_t WS_WT = 8 * MiB;
constexpr size_t W_QKV_NA = (size_t)3072 * 1024 * 2, W_QKV_G = (size_t)1536 * 1024 * 2, W_O = (size_t)1024 * 1024 * 2, W_UP = (size_t)NUP * 1024 * 2, W_DN = (size_t)1024 * DFF * 2;
constexpr size_t W_LAYER = W_QKV_NA + W_O + W_UP + W_DN;
constexpr size_t WS_HN = WS_WT + 4 * W_LAYER;
constexpr size_t SZ_ACT16 = (size_t)NTOK * D * 2;
constexpr size_t WS_A = WS_HN + SZ_ACT16;
constexpr size_t WS_Q = WS_A, WS_K = WS_A + SZ_ACT16, WS_V = WS_A + 2 * SZ_ACT16, WS_ATT = WS_A + 3 * SZ_ACT16, WS_O1 = WS_A + 4 * SZ_ACT16;
constexpr size_t WS_U = WS_A;
constexpr size_t SZ_A = 6 * SZ_ACT16;
constexpr size_t WS_ACT = WS_A + SZ_A;
constexpr size_t WS_END = WS_ACT + (size_t)NTOK * DFF * 2;
static_assert((size_t)NTOK * NUP * 2 <= SZ_A, "U fits region A");
static_assert(W_LAYER % 16 == 0 && WS_HN % 256 == 0, "alignment");
constexpr int CW_BAR = 4096;
static_assert((CW_BAR + XCD_BAR_WORDS) * 4 <= (int)CTL_ZERO_BYTES, "ctl");

constexpr size_t OUT_Y = 0, OUT_NAK = (size_t)NTOK * D, OUT_NAV = OUT_NAK + (size_t)32 * 2 * 256 * 1024, OUT_GK = OUT_NAV + (size_t)32 * 2 * 256 * 1024, OUT_GV = OUT_GK + (size_t)32 * 2 * 256 * 256;
constexpr size_t OUT_TOTAL = OUT_GV + (size_t)32 * 2 * 256 * 256;

constexpr int RING_BYTES = 131072, MISC_OFF = RING_BYTES + 320, LDS_BYTES = 147456;

__device__ __forceinline__ float wave_sum(float v) {
#pragma unroll
    for (int o = 1; o < 64; o <<= 1) v += __shfl_xor(v, o);
    return v;
}
#define LDS_WAIT() asm volatile("s_waitcnt lgkmcnt(0)" ::: "memory")

__device__ __forceinline__ int perm_row(int pmode, int n) {
    if (pmode == 1) return (n & ~255) + 128 * ((n >> 5) & 1) + 32 * ((n >> 6) & 3) + (n & 31);
    if (pmode == 2) { return n < DFF ? 256 * (n >> 7) + (n & 127) : 256 * ((n - DFF) >> 7) + 128 + ((n - DFF) & 127); }
    return n;
}
__device__ __forceinline__ void transpose_item(const float* W, int K, int N, bf16_t* WT, int pmode, LAS float* scr, int item, int lane) {
    const int nblk = N / 32, kb = item / nblk, nb = item % nblk, k0 = 64 * kb, n0 = 32 * nb;
    const int d0 = perm_row(pmode, n0);
#pragma unroll 8
    for (int i = 0; i < 32; ++i) { const int kk = 2 * i + (lane >> 5); scr[kk * 33 + (lane & 31)] = W[(size_t)(k0 + kk) * N + n0 + (lane & 31)]; }
    LDS_WAIT(); asm volatile("" ::: "memory");
    const int c = lane & 7;
#pragma unroll
    for (int j = 0; j < 4; ++j) { const int n = (lane >> 3) + 8 * j; const LAS float* s = scr + (8 * c) * 33 + n;
        u32x4 o; o.x = pk2(s[0 * 33], s[1 * 33]); o.y = pk2(s[2 * 33], s[3 * 33]); o.z = pk2(s[4 * 33], s[5 * 33]); o.w = pk2(s[6 * 33], s[7 * 33]);
        *(u32x4*)(WT + (size_t)(d0 + n) * K + k0 + 8 * c) = o; }
    LDS_WAIT(); asm volatile("" ::: "memory");
}

__device__ __forceinline__ void sincos_d(double x, double& s, double& c) {
    const double k = __builtin_rint(x * 0.6366197723675814);
    double r = __builtin_fma(-k, 1.5707963267948966, x); r = __builtin_fma(-k, 6.123233995736766e-17, r);
    const double r2 = r * r;
    double sp = 1.0 / 6227020800.0; sp = sp * r2 - 1.0 / 39916800.0; sp = sp * r2 + 1.0 / 362880.0; sp = sp * r2 - 1.0 / 5040.0; sp = sp * r2 + 1.0 / 120.0; sp = sp * r2 - 1.0 / 6.0; sp = sp * r2 + 1.0; sp = sp * r;
    double cp = -1.0 / 87178291200.0; cp = cp * r2 + 1.0 / 479001600.0; cp = cp * r2 - 1.0 / 3628800.0; cp = cp * r2 + 1.0 / 40320.0; cp = cp * r2 - 1.0 / 720.0; cp = cp * r2 + 1.0 / 24.0; cp = cp * r2 - 0.5; cp = cp * r2 + 1.0;
    const int q = ((int)k) & 3;
    s = (q == 0) ? sp : (q == 1) ? cp : (q == 2) ? -sp : -cp;
    c = (q == 0) ? cp : (q == 1) ? -sp : (q == 2) ? -cp : sp;
}

template <bool HAS_SRC, bool WRITE_HN>
__device__ __forceinline__ void row_update(const float* xin, float* xout, const float* src, const float* gate, const float* postg,
                                           const float* preg, const float* sc, const float* sh, bf16_t* hn, int lane) {
    f32x4 x[4];
#pragma unroll
    for (int j = 0; j < 4; ++j) x[j] = *((const f32x4*)xin + lane + 64 * j);
    if constexpr (HAS_SRC) {
        f32x4 s[4]; float ss = 0.f;
#pragma unroll
        for (int j = 0; j < 4; ++j) { s[j] = *((const f32x4*)src + lane + 64 * j); ss += (s[j][0] * s[j][0] + s[j][1] * s[j][1]) + (s[j][2] * s[j][2] + s[j][3] * s[j][3]); }
        const float r1 = 1.0f / sqrtf(wave_sum(ss) * (1.0f / D) + EPS);
#pragma unroll
        for (int j = 0; j < 4; ++j) { const f32x4 g = *((const f32x4*)gate + lane + 64 * j), pg = *((const f32x4*)postg + lane + 64 * j); x[j] = x[j] + g * (s[j] * r1 * pg); }
    }
#pragma unroll
    for (int j = 0; j < 4; ++j) *((f32x4*)xout + lane + 64 * j) = x[j];
    if constexpr (WRITE_HN) {
        float ss = 0.f;
#pragma unroll
        for (int j = 0; j < 4; ++j) ss += (x[j][0] * x[j][0] + x[j][1] * x[j][1]) + (x[j][2] * x[j][2] + x[j][3] * x[j][3]);
        const float r2 = 1.0f / sqrtf(wave_sum(ss) * (1.0f / D) + EPS);
#pragma unroll
        for (int j = 0; j < 4; ++j) { const f32x4 g = *((const f32x4*)preg + lane + 64 * j), c = *((const f32x4*)sc + lane + 64 * j), h = *((const f32x4*)sh + lane + 64 * j);
            const f32x4 y = x[j] * r2 * g * (1.0f + c) + h; u32x2 w; w.x = pk2(y[0], y[1]); w.y = pk2(y[2], y[3]); *((u32x2*)hn + lane + 64 * j) = w; }
    }
}

struct AttnP {
    const bf16_t *Q, *K, *V; bf16_t* O; int kvpitch;
    const bf16_t *CK, *CV;
    const float* rpb;
};
constexpr int ATT_KV = 0, ATT_RPB = 32768;

template <int MODE>
__device__ __forceinline__ void attn_unit(const AttnP& P, int uidx, LAS unsigned char* lds) {
    int tid = threadIdx.x; asm volatile("" : "+v"(tid)); const int lane = tid & 63, r32 = lane & 31, hi = lane >> 5; const int wid = __builtin_amdgcn_readfirstlane(tid >> 6);
    int b, h, qrow0, NT, lo = 0, myr = 0;
    if (MODE == 0) { b = uidx >> 4; h = uidx & 15; qrow0 = b * 256 + 32 * wid; NT = 4; }
    else if (MODE == 1) { b = uidx >> 7; h = (uidx >> 3) & 15; const int r0 = 4 * (uidx & 7); myr = r0 + (wid >> 1);
        qrow0 = NP + b * 2048 + myr * 64 + 32 * (wid & 1);
        const int rs0 = min(max(r0 - 4, 0), 24), rs3 = min(max(r0 + 3 - 4, 0), 24); lo = rs0; NT = 4 + (rs3 + 7 - rs0 + 1); }
    else { b = uidx >> 7; h = (uidx >> 3) & 15; qrow0 = NP + b * 2048 + 256 * (uidx & 7) + 32 * wid; NT = 36; }
    const int hk = (P.kvpitch == 256) ? (h >> 2) : h;
    bf16x8 qr[4];
    { const bf16_t* qp = P.Q + (size_t)(qrow0 + r32) * D + h * 64 + 8 * hi;
#pragma unroll
      for (int j = 0; j < 4; ++j) qr[j] = *(const bf16x8*)(qp + 16 * j); }
    if (MODE == 1) { LAS float* T = (LAS float*)(lds + ATT_RPB);
        for (int i = tid; i < 15 * 32; i += 512) { const int dr = i >> 5, dc = i & 31; T[i] = dc < 31 ? P.rpb[(h * 15 + dr) * 31 + dc] * LOG2E : 0.f; } }
    const int srow = tid >> 3, sch = tid & 7;
    const int kdst = sch * 1024 + ((srow ^ sch) * 16);
    const int vdst = 8192 + (sch >> 2) * 4096 + (srow >> 4) * 1024 + (srow & 15) * 64 + (sch & 3) * 16;
    auto tile_ptrs = [&](int j, const bf16_t*& kp, const bf16_t*& vp) {
        size_t off;
        if (MODE == 0) { off = (size_t)(b * 256 + 64 * j + srow) * P.kvpitch + hk * 64 + sch * 8; kp = P.K + off; vp = P.V + off; }
        else if (MODE == 1) {
            if (j < 4) { off = (size_t)(b * 512 + 64 * j + srow) * 1024 + h * 64 + sch * 8; kp = P.CK + off; vp = P.CV + off; }
            else { off = (size_t)(NP + b * 2048 + (lo + j - 4) * 64 + srow) * 1024 + h * 64 + sch * 8; kp = P.K + off; vp = P.V + off; } }
        else {
            if (j < 32) { off = (size_t)(NP + b * 2048 + 64 * j + srow) * 256 + hk * 64 + sch * 8; kp = P.K + off; vp = P.V + off; }
            else { off = (size_t)(b * 512 + 64 * (j - 32) + srow) * 256 + hk * 64 + sch * 8; kp = P.CK + off; vp = P.CV + off; } }
    };
    const int vrd = 8192 + ((lane >> 4) & 1) * 32 + (lane & 3) * 8 + (4 * hi + ((lane & 15) >> 2)) * 64;
    float mrun = -1e30f, lrun = 0.f; f32x16 oT[2]; oT[0] = f32x16{}; oT[1] = f32x16{};
    const int qc = 32 * (wid & 1) + r32;
    const int cs = min(max(qc - 8, 0), 48);
    const int myrs = min(max(myr - 4, 0), 24);
    u32x4 kreg, vreg;
    { const bf16_t *kp, *vp; tile_ptrs(0, kp, vp); kreg = *(const u32x4*)kp; vreg = *(const u32x4*)vp; }
    *(LAS u32x4*)(lds + ATT_KV + kdst) = kreg; *(LAS u32x4*)(lds + ATT_KV + vdst) = vreg;
    for (int j = 0; j < NT; ++j) {
        __syncthreads();
        const int boff = ATT_KV + (j & 1) * 16384;
        if (j + 1 < NT) { const bf16_t *kp, *vp; tile_ptrs(j + 1, kp, vp); kreg = *(const u32x4*)kp; vreg = *(const u32x4*)vp; }
        bool active = true; int kr = 0;
        if (MODE == 1 && j >= 4) { kr = lo + j - 4; active = (kr >= myrs) && (kr < myrs + 8); }
        if (active) {
            f32x16 p0 = f32x16{}, p1 = f32x16{};
#pragma unroll
            for (int jj = 0; jj < 4; ++jj) { const int c = 2 * jj + hi;
                const bf16x8 k0 = *(const LAS bf16x8*)(lds + boff + c * 1024 + ((r32 ^ c) * 16));
                const bf16x8 k1 = *(const LAS bf16x8*)(lds + boff + c * 1024 + (((32 + r32) ^ c) * 16));
                p0 = __builtin_amdgcn_mfma_f32_32x32x16_bf16(k0, qr[jj], p0, 0, 0, 0);
                p1 = __builtin_amdgcn_mfma_f32_32x32x16_bf16(k1, qr[jj], p1, 0, 0, 0); }
            if (MODE == 1 && j >= 4) {
                const LAS float* T = (const LAS float*)(lds + ATT_RPB) + (kr - myr + 7) * 32;
#pragma unroll
                for (int r = 0; r < 16; ++r) { const int kc = (r & 3) + 8 * (r >> 2) + 4 * hi;
                    { const int rel = kc - cs; const int idx = min(max(kc - qc + 15, 0), 30); const float bv = T[idx]; p0[r] = (rel >= 0 && rel < 16) ? p0[r] + bv : -1e30f; }
                    { const int kc2 = kc + 32; const int rel = kc2 - cs; const int idx = min(max(kc2 - qc + 15, 0), 30); const float bv = T[idx]; p1[r] = (rel >= 0 && rel < 16) ? p1[r] + bv : -1e30f; } }
            }
            float mx = fmaxf(p0[0], p1[0]);
#pragma unroll
            for (int r = 1; r < 16; ++r) mx = fmaxf(mx, fmaxf(p0[r], p1[r]));
            mx = fmaxf(mx, __shfl_xor(mx, 32));
            const float mnew = fmaxf(mrun, mx); const float alpha = __builtin_amdgcn_exp2f(mrun - mnew); mrun = mnew;
            float ps = 0.f;
#pragma unroll
            for (int r = 0; r < 16; ++r) { p0[r] = __builtin_amdgcn_exp2f(p0[r] - mnew); p1[r] = __builtin_amdgcn_exp2f(p1[r] - mnew); ps += p0[r] + p1[r]; }
            lrun = lrun * alpha + ps;
#pragma unroll
            for (int r = 0; r < 16; ++r) { oT[0][r] *= alpha; oT[1][r] *= alpha; }
            u32x4 pw[4];
#pragma unroll
            for (int w = 0; w < 4; ++w) { pw[0][w] = pk2(p0[2 * w], p0[2 * w + 1]); pw[1][w] = pk2(p0[8 + 2 * w], p0[9 + 2 * w]); pw[2][w] = pk2(p1[2 * w], p1[2 * w + 1]); pw[3][w] = pk2(p1[8 + 2 * w], p1[9 + 2 * w]); }
#pragma unroll
            for (int dh = 0; dh < 2; ++dh)
#pragma unroll
                for (int s = 0; s < 4; ++s) {
                    const s16x4 vl = __builtin_bit_cast(s16x4, __builtin_amdgcn_ds_read_tr16_b64_v4i16((LAS s16x4*)(lds + boff + vrd + dh * 4096 + s * 1024)));
                    const s16x4 vh = __builtin_bit_cast(s16x4, __builtin_amdgcn_ds_read_tr16_b64_v4i16((LAS s16x4*)(lds + boff + vrd + dh * 4096 + s * 1024 + 512)));
                    const bf16x8 vf = (bf16x8){vl[0], vl[1], vl[2], vl[3], vh[0], vh[1], vh[2], vh[3]};
                    oT[dh] = __builtin_amdgcn_mfma_f32_32x32x16_bf16(vf, __builtin_bit_cast(bf16x8, pw[s]), oT[dh], 0, 0, 0);
                }
        }
        if (j + 1 < NT) { const int nb = ATT_KV + ((j + 1) & 1) * 16384; *(LAS u32x4*)(lds + nb + kdst) = kreg; *(LAS u32x4*)(lds + nb + vdst) = vreg; }
    }
    const float ltot = lrun + __shfl_xor(lrun, 32); const float inv = 1.0f / ltot;
    bf16_t* op = P.O + (size_t)(qrow0 + r32) * D + h * 64 + 4 * hi;
#pragma unroll
    for (int dh = 0; dh < 2; ++dh)
#pragma unroll
        for (int g = 0; g < 4; ++g) { u32x2 w; w.x = pk2(oT[dh][4 * g] * inv, oT[dh][4 * g + 1] * inv); w.y = pk2(oT[dh][4 * g + 2] * inv, oT[dh][4 * g + 3] * inv); *(u32x2*)(op + 32 * dh + 8 * g) = w; }
    __syncthreads();
}

struct Args { const float* in[25]; float* out; unsigned char* ws; unsigned long long pad; };

__global__ void __launch_bounds__(512, 2) mega_fwd(Args args) {
    extern __shared__ __attribute__((aligned(16))) unsigned char lds_raw[];
    LAS unsigned char* lds = (LAS unsigned char*)lds_raw;
    volatile LAS unsigned* MISC = (volatile LAS unsigned*)(lds + MISC_OFF);
#define PH_IDS() int tid = threadIdx.x; asm volatile("" : "+v"(tid)); const int lane = tid & 63; const int wave = __builtin_amdgcn_readfirstlane(tid >> 6); const int gw = vcu * 8 + wave; (void)lane; (void)gw
    const int G = gridDim.x, bx = blockIdx.x;
    const int vcu = (G % 8 == 0) ? (bx % 8) * (G / 8) + bx / 8 : bx;
    unsigned char* ws = args.ws;
    for (int u = threadIdx.x; u < (LDS_BYTES - RING_BYTES) / 4; u += 512) ((LAS unsigned*)(lds + RING_BYTES))[u] = 0u;
    __syncthreads();
    XcdBarrier bar = xcd_barrier_post((unsigned*)(ws + WS_CTL) + CW_BAR, MISC + 8);
#define GRID_BAR() xcd_barrier(bar)

    const float* x_prompt = args.in[0]; const float* x_sample = args.in[1];
    const float* c_in = args.in[6]; const float* c_ctx = args.in[7];
    const float* ada_w = args.in[8]; const float* ada_b = args.in[9];
    const float* n_mix_pre = args.in[10]; const float* n_mix_post = args.in[11]; const float* n_ffn_pre = args.in[12]; const float* n_ffn_post = args.in[13];
    float* X = args.out + OUT_Y;
    float* MOD = (float*)(ws + WS_MOD);
    float* ROPEC = (float*)(ws + WS_ROPE); float* ROPES = ROPEC + 64 * 16;
    bf16_t* HN = (bf16_t*)(ws + WS_HN);
    const int NGW = G * 8;

    {
        PH_IDS();
        for (int un = bx; un < 192; un += G) {
            const int l = un / 48, g = un % 48;
            LAS float* sl = (LAS float*)lds; LAS float* red = sl + 3072;
            for (int i = tid; i < 3072; i += 512) { const int cn = i >> 10, k = i & 1023; const float v = cn == 0 ? c_ctx[k] : c_in[(cn - 1) * 1024 + k]; sl[i] = v / (1.0f + __expf(-v)); }
            __syncthreads();
            const float* wp = ada_w + (size_t)l * 1024 * 6144 + (size_t)(128 * wave) * 6144 + 128 * g + 2 * lane;
            float a00 = 0.f, a01 = 0.f, a10 = 0.f, a11 = 0.f, a20 = 0.f, a21 = 0.f;
#pragma unroll 8
            for (int k = 0; k < 128; ++k) { const f32x2 w = *(const f32x2*)(wp + (size_t)k * 6144); const int kk = 128 * wave + k;
                const float s0 = sl[kk], s1 = sl[1024 + kk], s2 = sl[2048 + kk];
                a00 += s0 * w.x; a01 += s0 * w.y; a10 += s1 * w.x; a11 += s1 * w.y; a20 += s2 * w.x; a21 += s2 * w.y; }
            red[(wave * 3 + 0) * 128 + 2 * lane] = a00; red[(wave * 3 + 0) * 128 + 2 * lane + 1] = a01;
            red[(wave * 3 + 1) * 128 + 2 * lane] = a10; red[(wave * 3 + 1) * 128 + 2 * lane + 1] = a11;
            red[(wave * 3 + 2) * 128 + 2 * lane] = a20; red[(wave * 3 + 2) * 128 + 2 * lane + 1] = a21;
            __syncthreads();
            if (tid < 384) { const int cn = tid >> 7, n = tid & 127; float s = ada_b[l * 6144 + 128 * g + n];
#pragma unroll
                for (int w = 0; w < 8; ++w) s += red[(w * 3 + cn) * 128 + n];
                MOD[(size_t)(l * 3 + cn) * 6144 + 128 * g + n] = s; }
            __syncthreads();
        }
        if (bx == G - 1) {
            for (int i = tid; i < 1024; i += 512) { const int p = i >> 4, f = i & 15;
                const double fr[16] = {1.0, 0.5623413251903491, 0.31622776601683794, 0.1778279410038923, 0.1, 0.05623413251903491, 0.03162277660168379, 0.01778279410038923,
                                       0.01, 0.005623413251903491, 0.0031622776601683794, 0.0017782794100389228, 0.001, 0.0005623413251903491, 0.00031622776601683794, 0.00017782794100389227};
                double fv = fr[0];
#pragma unroll
                for (int q = 1; q < 16; ++q) fv = (f == q) ? fr[q] : fv;
                double s, c; sincos_d((double)p * fv, s, c); ROPEC[i] = (float)c; ROPES[i] = (float)s; }
        }
        {
            LAS float* scr = (LAS float*)(lds + wave * 16384);
            constexpr int I_QN = 16 * 96, I_QG = 16 * 48, I_O = 16 * 32, I_UP = 16 * 176, I_DN = 44 * 32;
            constexpr int I_NA = I_QN + I_O + I_UP + I_DN, I_G = I_QG + I_O + I_UP + I_DN, I_ALL = 2 * (I_NA + I_G);
            for (int it = gw; it < I_ALL; it += NGW) {
                int r = it; int l;
                if (r < I_NA) l = 0; else if ((r -= I_NA) < I_G) l = 1; else if ((r -= I_G) < I_NA) l = 2; else { r -= I_NA; l = 3; }
                const int i2 = l >> 1; const bool gq = l & 1;
                bf16_t* wl = (bf16_t*)(ws + WS_WT + (size_t)l * W_LAYER);
                const int iq = gq ? I_QG : I_QN;
                if (r < iq) { if (gq) transpose_item(args.in[17] + (size_t)i2 * 1024 * 1536, 1024, 1536, wl, 1, scr, r, lane); else transpose_item(args.in[14] + (size_t)i2 * 1024 * 3072, 1024, 3072, wl, 1, scr, r, lane); continue; }
                r -= iq;
                if (r < I_O) { transpose_item((gq ? args.in[18] : args.in[15]) + (size_t)i2 * 1024 * 1024, 1024, 1024, (bf16_t*)((unsigned char*)wl + W_QKV_NA), 0, scr, r, lane); continue; }
                r -= I_O;
                if (r < I_UP) { transpose_item(args.in[21] + (size_t)l * 1024 * NUP, 1024, NUP, (bf16_t*)((unsigned char*)wl + W_QKV_NA + W_O), 2, scr, r, lane); continue; }
                r -= I_UP;
                transpose_item(args.in[24] + (size_t)l * DFF * 1024, DFF, 1024, (bf16_t*)((unsigned char*)wl + W_QKV_NA + W_O + W_UP), 0, scr, r, lane);
            }
        }
        {
            const int gt = vcu * 512 + tid, NGT = G * 512;
            constexpr int C_NA = 2 * 2 * 256 * 1024 / 4, C_G = 2 * 2 * 256 * 256 / 4;
            for (int i = gt; i < 2 * C_NA + 2 * C_G; i += NGT) {
                const float* src; bf16_t* dst; int j = i;
                if (j < C_NA) { src = args.in[2]; dst = (bf16_t*)(ws + WS_CNK); } else if ((j -= C_NA) < C_NA) { src = args.in[3]; dst = (bf16_t*)(ws + WS_CNV); }
                else if ((j -= C_NA) < C_G) { src = args.in[4]; dst = (bf16_t*)(ws + WS_CGK); } else { j -= C_G; src = args.in[5]; dst = (bf16_t*)(ws + WS_CGV); }
                const f32x4 v = *((const f32x4*)src + j); u32x2 w; w.x = pk2(v[0], v[1]); w.y = pk2(v[2], v[3]); *((u32x2*)dst + j) = w;
            }
        }
    }
    GRID_BAR();
    { PH_IDS();
    for (int m = gw; m < NTOK; m += NGW) {
        const int cn = m < NP ? 0 : 1 + ((m - NP) >> 11);
        const float* md = MOD + (size_t)(0 * 3 + cn) * 6144;
        const float* xin = m < NP ? x_prompt + (size_t)m * D : x_sample + (size_t)(m - NP) * D;
        row_update<false, true>(xin, X + (size_t)m * D, nullptr, nullptr, nullptr, n_mix_pre, md + 1024, md, HN + (size_t)m * D, lane);
    } }
    GRID_BAR();

#pragma unroll 1
    for (int l = 0; l < 4; ++l) {
        const int i2 = l >> 1; const int gq = l & 1;
        const unsigned char* wl = ws + WS_WT + (size_t)l * W_LAYER;
        const int kvpitch = gq ? 256 : 1024;
        bf16_t* Qb = (bf16_t*)(ws + WS_Q); bf16_t* Kb = (bf16_t*)(ws + WS_K); bf16_t* Vb = (bf16_t*)(ws + WS_V); bf16_t* ATT = (bf16_t*)(ws + WS_ATT);
        float* O1 = (float*)(ws + WS_O1);
        {
            pg8::Gemm g{HN, (const bf16_t*)wl, NTOK, gq ? 1536 : 3072, 1024}; pg8::StaticOrder S; S.init(NTOK, g.N, G, bx);
            EpiQKV E; E.Q = Qb; E.K = Kb; E.V = Vb; E.kvpitch = kvpitch; E.gqa = gq;
            E.outk = args.out + (gq ? OUT_GK : OUT_NAK) + (size_t)i2 * 256 * kvpitch; E.outv = args.out + (gq ? OUT_GV : OUT_NAV) + (size_t)i2 * 256 * kvpitch;
            E.qn = args.in[19] + i2 * 64; E.kn = args.in[20] + i2 * 64; E.ropec = ROPEC; E.ropes = ROPES;
            pg8::gemm_phase<EpiQKV, pg8::StaticOrder, true, true>(lds, g, S, E);
        }
        GRID_BAR();
        {
            AttnP P; P.Q = Qb; P.K = Kb; P.V = Vb; P.O = ATT; P.kvpitch = kvpitch;
            P.CK = (const bf16_t*)(ws + (gq ? WS_CGK : WS_CNK)) + (size_t)i2 * 256 * kvpitch; P.CV = (const bf16_t*)(ws + (gq ? WS_CGV : WS_CNV)) + (size_t)i2 * 256 * kvpitch;
            P.rpb = args.in[16] + (size_t)i2 * 16 * 15 * 31;
            for (int un = vcu; un < 256; un += G) { if (gq) attn_unit<2>(P, un, lds); else attn_unit<1>(P, un, lds); }
            for (int un = vcu; un < 512; un += G) attn_unit<0>(P, un, lds);
        }
        GRID_BAR();
        {
            pg8::Gemm g{ATT, (const bf16_t*)(wl + W_QKV_NA), NTOK, 1024, 1024}; pg8::StaticOrder S; S.init(NTOK, 1024, G, bx);
            EpiF32 E; E.out = O1;
            pg8::gemm_phase<EpiF32, pg8::StaticOrder, true, true>(lds, g, S, E);
        }
        GRID_BAR();
        { PH_IDS();
        for (int m = gw; m < NTOK; m += NGW) {
            const int cn = m < NP ? 0 : 1 + ((m - NP) >> 11);
            const float* md = MOD + (size_t)(l * 3 + cn) * 6144;
            row_update<true, true>(X + (size_t)m * D, X + (size_t)m * D, O1 + (size_t)m * D, md + 2 * 1024, n_mix_post + l * 1024, n_ffn_pre + l * 1024, md + 4 * 1024, md + 3 * 1024, HN + (size_t)m * D, lane);
        } }
        GRID_BAR();
        bf16_t* U = (bf16_t*)(ws + WS_U); bf16_t* ACT = (bf16_t*)(ws + WS_ACT);
        {
            pg8::Gemm g{HN, (const bf16_t*)(wl + W_QKV_NA + W_O), NTOK, NUP, 1024}; pg8::StaticOrder S; S.init(NTOK, NUP, G, bx);
            EpiUp E; E.U = U;
            pg8::gemm_phase<EpiUp, pg8::StaticOrder, true, true>(lds, g, S, E);
        }
        GRID_BAR();
        {
            PH_IDS();
            const float* cw = args.in[22] + (size_t)l * 3 * NUP; const float* cb = args.in[23] + (size_t)l * NUP;
            const int gt = vcu * 512 + tid, NGT = G * 512;
            for (int it = gt; it < (NTOK / 32) * 352; it += NGT) {
                const int rb = it / 352, cc = it % 352; const int m0 = rb * 32, c0 = cc * 8;
                const int seq = m0 < NP ? 256 : 2048; const int ms = m0 < NP ? m0 : m0 - NP;
                const bool first = (ms % seq) == 0, lastb = ((ms + 32) % seq) == 0;
                float wa[3][8], wg[3][8], ba[8], bg[8];
#pragma unroll
                for (int t = 0; t < 3; ++t)
#pragma unroll
                    for (int e = 0; e < 8; ++e) { wa[t][e] = cw[t * NUP + c0 + e]; wg[t][e] = cw[t * NUP + DFF + c0 + e]; }
#pragma unroll
                for (int e = 0; e < 8; ++e) { ba[e] = cb[c0 + e]; bg[e] = cb[DFF + c0 + e]; }
                const bf16_t* up = U + (size_t)m0 * NUP + c0;
                u32x4 pa, pg_, ca, cg, na, ng;
                if (first) { pa = (u32x4){0u, 0u, 0u, 0u}; pg_ = pa; } else { pa = *(const u32x4*)(up - NUP); pg_ = *(const u32x4*)(up - NUP + DFF); }
                ca = *(const u32x4*)(up); cg = *(const u32x4*)(up + DFF);
#pragma unroll 4
                for (int rr = 0; rr < 32; ++rr) {
                    if (rr == 31 && lastb) { na = (u32x4){0u, 0u, 0u, 0u}; ng = na; } else { na = *(const u32x4*)(up + (size_t)(rr + 1) * NUP); ng = *(const u32x4*)(up + (size_t)(rr + 1) * NUP + DFF); }
                    u32x4 o;
#pragma unroll
                    for (int w = 0; w < 4; ++w) {
                        float r2[2];
#pragma unroll
                        for (int hh = 0; hh < 2; ++hh) { const int e = 2 * w + hh; const int sh = 16 * hh;
                            const float ua = wa[0][e] * bf2f((unsigned short)(pa[w] >> sh)) + wa[1][e] * bf2f((unsigned short)(ca[w] >> sh)) + wa[2][e] * bf2f((unsigned short)(na[w] >> sh)) + ba[e];
                            const float ug = wg[0][e] * bf2f((unsigned short)(pg_[w] >> sh)) + wg[1][e] * bf2f((unsigned short)(cg[w] >> sh)) + wg[2][e] * bf2f((unsigned short)(ng[w] >> sh)) + bg[e];
                            r2[hh] = ua / (1.0f + __expf(-ua)) * ug; }
                        o[w] = pk2(r2[0], r2[1]);
                    }
                    *(u32x4*)(ACT + (size_t)(m0 + rr) * DFF + c0) = o;
                    pa = ca; pg_ = cg; ca = na; cg = ng;
                }
            }
        }
        GRID_BAR();
        {
            pg8::Gemm g{ACT, (const bf16_t*)(wl + W_QKV_NA + W_O + W_UP), NTOK, 1024, DFF}; pg8::StaticOrder S; S.init(NTOK, 1024, G, bx);
            EpiF32 E; E.out = O1;
            pg8::gemm_phase<EpiF32, pg8::StaticOrder, true, true>(lds, g, S, E);
        }
        GRID_BAR();
        { PH_IDS();
        for (int m = gw; m < NTOK; m += NGW) {
            const int cn = m < NP ? 0 : 1 + ((m - NP) >> 11);
            const float* md = MOD + (size_t)(l * 3 + cn) * 6144;
            if (l < 3) { const float* mdn = MOD + (size_t)((l + 1) * 3 + cn) * 6144;
                row_update<true, true>(X + (size_t)m * D, X + (size_t)m * D, O1 + (size_t)m * D, md + 5 * 1024, n_ffn_post + l * 1024, n_mix_pre + (l + 1) * 1024, mdn + 1024, mdn, HN + (size_t)m * D, lane); }
            else row_update<true, false>(X + (size_t)m * D, X + (size_t)m * D, O1 + (size_t)m * D, md + 5 * 1024, n_ffn_post + l * 1024, nullptr, nullptr, nullptr, nullptr, lane);
        } }
        if (l < 3) GRID_BAR();
    }
}

extern "C" void kernel_launch(void* const* d_in, const int* in_sizes, int n_in, void* d_out, int out_size, void* d_ws, size_t ws_size, hipStream_t stream) {
    static int grid = 0;
    if (grid == 0) {
        if (n_in != 25 || (size_t)out_size != OUT_TOTAL || ws_size < WS_END) { fprintf(stderr, "kernel_launch: unexpected shapes (n_in %d out %d ws %zu need %zu)\n", n_in, out_size, ws_size, (size_t)WS_END); grid = -1; return; }
        int dev = 0, cus = 0, per_cu = 0;
        if (hipGetDevice(&dev) != hipSuccess || hipDeviceGetAttribute(&cus, hipDeviceAttributeMultiprocessorCount, dev) != hipSuccess) { grid = -1; return; }
        if (hipFuncSetAttribute((const void*)mega_fwd, hipFuncAttributeMaxDynamicSharedMemorySize, LDS_BYTES) != hipSuccess) { grid = -1; return; }
        if (hipOccupancyMaxActiveBlocksPerMultiprocessor(&per_cu, (const void*)mega_fwd, 512, LDS_BYTES) != hipSuccess || per_cu < 1) { fprintf(stderr, "kernel_launch: occupancy query says %d\n", per_cu); grid = -1; (void)hipGetLastError(); return; }
        grid = cus;
    }
    if (grid < 0) return;
    if (hipMemsetAsync((char*)d_ws + WS_CTL, 0, CTL_ZERO_BYTES, stream) != hipSuccess) return;
    Args a{};
    for (int i = 0; i < 25; ++i) a.in[i] = (const float*)d_in[i];
    a.out = (float*)d_out; a.ws = (unsigned char*)d_ws; a.pad = 0ull;
    void* kargs[] = {&a};
    hipError_t e = hipLaunchCooperativeKernel((const void*)mega_fwd, dim3(grid), dim3(512), kargs, LDS_BYTES, stream);
    if (e != hipSuccess) fprintf(stderr, "kernel_launch: cooperative launch failed: %s (grid %d)\n", hipGetErrorString(e), grid);
}
```
